# Optimizing an MI355X kernel written in HIP

```python
import jax
import jax.numpy as jnp
from jax import lax
import numpy as np


D_MODEL = 1024
BATCH = 16
SEQ = 4096
DEPTH = 2

D_FF = 2816
A_HEADS = 8
A_KV_HEADS = 2
A_HEAD_DIM = 64
WINDOW = 128
A_BLOCK = 128
B_HEADS = 4
B_KEY_DIM = 128
B_VAL_DIM = 128
B_CHUNK = 64
C_HEADS = 16
C_Q_RANK = 256
C_KV_RANK = 256
C_NOPE = 64
C_ROPE = 32
C_V = 64
C_QBLOCK = 128
ROPE_THETA = 10000.0
LN_EPS = 1e-5
RMS_EPS = 1e-6
DEEPNORM_ALPHA = (2 * DEPTH) ** 0.25
DEEPNORM_BETA = (8 * DEPTH) ** -0.25
N_EVEN = (DEPTH + 1) // 2
N_ODD = DEPTH // 2
N_SUB = 3
A_Q_W = A_HEADS * A_HEAD_DIM
A_KV_W = A_KV_HEADS * A_HEAD_DIM
B_K_W = B_HEADS * B_KEY_DIM
B_V_W = B_HEADS * B_VAL_DIM
HYB_SPLITS = (A_Q_W, A_KV_W, A_KV_W, B_K_W, B_K_W, B_K_W, B_V_W, B_V_W)
HYB_IN = sum(HYB_SPLITS)
HYB_OUT = A_Q_W + B_V_W
MLA_DOWN = C_Q_RANK + C_KV_RANK + C_ROPE
F32 = jnp.float32

kernel_name = 'hybrid_swa_hgrn2_mla_macaron_deepnorm_adaln'


def layer_norm(x, g, b):
    xf = x.astype(F32)
    mu = jnp.mean(xf, -1, keepdims=True)
    var = jnp.mean(jnp.square(xf - mu), -1, keepdims=True)
    return ((xf - mu) * lax.rsqrt(var + LN_EPS) * g + b).astype(x.dtype)


def rms_norm(x, w):
    xf = x.astype(F32)
    return (xf * lax.rsqrt(jnp.mean(xf * xf, -1, keepdims=True) + RMS_EPS) * w).astype(x.dtype)


def swiglu(h, w_gate, w_up, w_down):
    return (jax.nn.silu(h @ w_gate) * (h @ w_up)) @ w_down


def rope(x, pos):
    half = x.shape[-1] // 2
    freqs = ROPE_THETA ** (-jnp.arange(half, dtype=F32) / half)
    ang = pos.astype(F32)[..., None] * freqs
    ang = ang.reshape(ang.shape[:2] + (1,) * (x.ndim - 3) + (half,))
    cos, sin = jnp.cos(ang), jnp.sin(ang)
    x1, x2 = x[..., :half].astype(F32), x[..., half:].astype(F32)
    return jnp.concatenate([x1 * cos - x2 * sin, x1 * sin + x2 * cos], -1).astype(x.dtype)


def alibi_slopes(n):
    return 2.0 ** (-8.0 * jnp.arange(1, n + 1, dtype=F32) / n)


def window_attention(q, k, v, pos, sink):
    bsz, seq = q.shape[:2]
    nb = seq // A_BLOCK
    grp = A_HEADS // A_KV_HEADS

    def band(t):
        tp = jnp.pad(t, [(0, 0), (A_BLOCK, A_BLOCK)] + [(0, 0)] * (t.ndim - 2))
        tb = tp.reshape((bsz, nb + 2, A_BLOCK) + t.shape[2:])
        return jnp.concatenate([tb[:, :-2], tb[:, 1:-1], tb[:, 2:]], axis=2)

    kb, vb, pk = band(k), band(v), band(pos)
    qb = q.reshape(bsz, nb, A_BLOCK, A_KV_HEADS, grp, A_HEAD_DIM)
    pq = pos.reshape(bsz, nb, A_BLOCK)
    s = jnp.einsum('bnqhgd,bnkhd->bnhgqk', qb, kb).astype(F32) * (A_HEAD_DIM ** -0.5)
    qi = jnp.arange(A_BLOCK)[:, None] + A_BLOCK
    ki = jnp.arange(3 * A_BLOCK)[None, :]
    abs_k = jnp.arange(nb)[:, None, None] * A_BLOCK + ki[None] - A_BLOCK
    valid = (jnp.abs(qi - ki) <= WINDOW)[None] & (abs_k >= 0) & (abs_k < seq)
    dist = jnp.abs(pq[..., :, None] - pk[..., None, :]).astype(F32)
    slopes = alibi_slopes(A_HEADS).reshape(A_KV_HEADS, grp)[None, None, :, :, None, None]
    s = s - slopes * dist[:, :, None, None]
    s = jnp.where(valid[None, :, None, None], s, -jnp.inf)
    sink_l = sink.astype(F32).reshape(A_KV_HEADS, grp)[None, None, :, :, None, None]
    m = jnp.maximum(jnp.max(s, -1, keepdims=True), sink_l)
    p = jnp.exp(s - m)
    p = p / (jnp.sum(p, -1, keepdims=True) + jnp.exp(sink_l - m))
    o = jnp.einsum('bnhgqk,bnkhd->bnqhgd', p.astype(v.dtype), vb)
    return o.reshape(bsz, seq, A_Q_W)


def hgrn2_scan(q, k, v, logf):
    bsz, nh, seq, dk = q.shape
    dv = v.shape[-1]
    n = seq // B_CHUNK
    q, k, logf = [t.reshape(bsz, nh, n, B_CHUNK, dk) for t in (q, k, logf)]
    v = v.reshape(bsz, nh, n, B_CHUNK, dv)
    b = jnp.cumsum(logf, axis=3)
    b_mid = b[:, :, :, B_CHUNK // 2 - 1:B_CHUNK // 2]
    b_end = b[:, :, :, -1:]
    a = jnp.einsum('bhnck,bhnsk->bhncs', q * jnp.exp(b - b_mid), k * jnp.exp(b_mid - b))
    tri = jnp.tril(jnp.ones((B_CHUNK, B_CHUNK), bool))
    o_intra = jnp.einsum('bhncs,bhnsv->bhncv', jnp.where(tri, a, 0.0), v)
    d_state = jnp.einsum('bhnck,bhncv->bhnkv', k * jnp.exp(b_end - b), v)
    decay = jnp.exp(b_end[:, :, :, 0])

    def step(s_prev, inp):
        dec, ds = inp
        return dec[..., None] * s_prev + ds, s_prev

    _, s0 = lax.scan(step, jnp.zeros((bsz, nh, dk, dv), q.dtype),
                     (jnp.moveaxis(decay, 2, 0), jnp.moveaxis(d_state, 2, 0)))
    s0 = jnp.moveaxis(s0, 0, 2)
    o_inter = jnp.einsum('bhnck,bhnkv->bhncv', q * jnp.exp(b), s0)
    return (o_intra + o_inter).reshape(bsz, nh, seq, dv)


def hgrn2_bidir(hq, hff, hfb, hi, hg, lb, norm_w):
    bsz, seq = hq.shape[:2]

    def heads(t, d):
        return t.reshape(bsz, seq, B_HEADS, d).transpose(0, 2, 1, 3).astype(F32)

    q = jax.nn.silu(heads(hq, B_KEY_DIM))
    v = heads(hi, B_VAL_DIM)
    lbh = lb.astype(F32).reshape(B_HEADS, 1, B_KEY_DIM)

    def gates(hf):
        f = lbh + (1.0 - lbh) * jax.nn.sigmoid(heads(hf, B_KEY_DIM))
        return 1.0 - f, jnp.log(f)

    k_f, g_f = gates(hff)
    k_b, g_b = gates(hfb)
    flip = lambda t: jnp.flip(t, axis=2)
    o = hgrn2_scan(q, k_f, v, g_f) + flip(hgrn2_scan(flip(q), flip(k_b), flip(v), flip(g_b)))
    o = rms_norm(o, norm_w[:, None, :])
    o = o.transpose(0, 2, 1, 3).reshape(bsz, seq, B_V_W).astype(hg.dtype)
    return o * jax.nn.silu(hg)


def hybrid_mixer(h, pos, w_in, w_out, sink, lb, norm_w):
    bsz, seq, _ = h.shape
    offs = [int(o) for o in np.cumsum(HYB_SPLITS)[:-1]]
    aq, ak, av, bq, bff, bfb, bi, bg = jnp.split(h @ w_in, offs, axis=-1)
    o_a = window_attention(aq.reshape(bsz, seq, A_HEADS, A_HEAD_DIM),
                           ak.reshape(bsz, seq, A_KV_HEADS, A_HEAD_DIM),
                           av.reshape(bsz, seq, A_KV_HEADS, A_HEAD_DIM), pos, sink)
    o_b = hgrn2_bidir(bq, bff, bfb, bi, bg, lb, norm_w)
    return jnp.concatenate([o_a, o_b], axis=-1) @ w_out


def mla(h, pos, w_down, q_norm, kv_norm, w_uq, w_ukv, w_out):
    bsz, seq, _ = h.shape
    cq, ckv, kr = jnp.split(h @ w_down, [C_Q_RANK, C_Q_RANK + C_KV_RANK], axis=-1)
    q = (rms_norm(cq, q_norm) @ w_uq).reshape(bsz, seq, C_HEADS, C_NOPE + C_ROPE)
    q_nope, q_rope = q[..., :C_NOPE], rope(q[..., C_NOPE:], pos)
    kv = (rms_norm(ckv, kv_norm) @ w_ukv).reshape(bsz, seq, C_HEADS, C_NOPE + C_V)
    k_nope, v = kv[..., :C_NOPE], kv[..., C_NOPE:]
    k_rope = rope(kr, pos)
    scale = (C_NOPE + C_ROPE) ** -0.5
    nq = seq // C_QBLOCK
    qn_b = q_nope.reshape(bsz, nq, C_QBLOCK, C_HEADS, C_NOPE).swapaxes(0, 1)
    qr_b = q_rope.reshape(bsz, nq, C_QBLOCK, C_HEADS, C_ROPE).swapaxes(0, 1)

    def block(args):
        qn_i, qr_i = args
        s = (jnp.einsum('bqhd,bkhd->bhqk', qn_i, k_nope)
             + jnp.einsum('bqhr,bkr->bhqk', qr_i, k_rope)).astype(F32) * scale
        p = jax.nn.softmax(s, axis=-1).astype(v.dtype)
        return jnp.einsum('bhqk,bkhd->bqhd', p, v)

    o = lax.map(block, (qn_b, qr_b))
    return o.swapaxes(0, 1).reshape(bsz, seq, C_HEADS * C_V) @ w_out


def modulated_sublayer(x, mod, g, b, fn, res_w):
    shift, scale, gate = mod[:, 0, None, :], mod[:, 1, None, :], mod[:, 2, None, :]
    y = fn(x * (1.0 + scale) + shift)
    return layer_norm(DEEPNORM_ALPHA * x + res_w * (1.0 + gate) * y, g, b)


def setup_inputs(seed: int = 0) -> dict:
    key = jax.random.key(seed)
    ks = jax.random.split(key, 24)
    nrm = lambda k, shape, s: jax.random.normal(k, shape, F32) * s
    d = D_MODEL
    return {
        'x': nrm(ks[0], (BATCH, SEQ, d), 1.0),
        'c': nrm(ks[1], (BATCH, d), 1.0),
        'positions': jnp.broadcast_to(jnp.arange(SEQ, dtype=jnp.int32), (BATCH, SEQ)),
        'ada_w': nrm(ks[2], (DEPTH, d, N_SUB * 3 * d), 0.1 * d ** -0.5),
        'ada_b': nrm(ks[3], (DEPTH, N_SUB * 3 * d), 0.01),
        'ln_g': 1.0 + nrm(ks[4], (DEPTH, N_SUB, d), 0.01),
        'ln_b': nrm(ks[5], (DEPTH, N_SUB, d), 0.01),
        'ffn_w_gate': nrm(ks[6], (DEPTH, 2, d, D_FF), d ** -0.5),
        'ffn_w_up': nrm(ks[7], (DEPTH, 2, d, D_FF), d ** -0.5),
        'ffn_w_down': nrm(ks[8], (DEPTH, 2, D_FF, d), DEEPNORM_BETA * D_FF ** -0.5),
        'hyb_w_in': nrm(ks[9], (N_EVEN, d, HYB_IN), d ** -0.5),
        'hyb_w_out': nrm(ks[10], (N_EVEN, HYB_OUT, d), DEEPNORM_BETA * HYB_OUT ** -0.5),
        'attn_sink': nrm(ks[11], (N_EVEN, A_HEADS), 0.5),
        'hgrn_lb_logits': nrm(ks[12], (DEPTH + 1, B_K_W), 0.1),
        'hgrn_norm_w': 1.0 + nrm(ks[13], (N_EVEN, B_HEADS, B_VAL_DIM), 0.01),
        'mla_w_down': nrm(ks[14], (N_ODD, d, MLA_DOWN), d ** -0.5),
        'mla_q_norm': 1.0 + nrm(ks[15], (N_ODD, C_Q_RANK), 0.01),
        'mla_kv_norm': 1.0 + nrm(ks[16], (N_ODD, C_KV_RANK), 0.01),
        'mla_w_uq': nrm(ks[17], (N_ODD, C_Q_RANK, C_HEADS * (C_NOPE + C_ROPE)), C_Q_RANK ** -0.5),
        'mla_w_ukv': nrm(ks[18], (N_ODD, C_KV_RANK, C_HEADS * (C_NOPE + C_V)), C_KV_RANK ** -0.5),
        'mla_w_out': nrm(ks[19], (N_ODD, C_HEADS * C_V, d), DEEPNORM_BETA * (C_HEADS * C_V) ** -0.5),
    }


def reference(x, c, positions, ada_w, ada_b, ln_g, ln_b, ffn_w_gate, ffn_w_up, ffn_w_down,
              hyb_w_in, hyb_w_out, attn_sink, hgrn_lb_logits, hgrn_norm_w,
              mla_w_down, mla_q_norm, mla_kv_norm, mla_w_uq, mla_w_ukv, mla_w_out):
    bsz = x.shape[0]
    cond = jax.nn.silu(c)
    lb_all = jnp.cumsum(jax.nn.softmax(hgrn_lb_logits.astype(F32), axis=0), axis=0)
    for layer in range(DEPTH):
        mod = (cond @ ada_w[layer] + ada_b[layer]).reshape(bsz, N_SUB, 3, D_MODEL)
        ffn_pre = lambda h, l=layer: swiglu(h, ffn_w_gate[l, 0], ffn_w_up[l, 0], ffn_w_down[l, 0])
        ffn_post = lambda h, l=layer: swiglu(h, ffn_w_gate[l, 1], ffn_w_up[l, 1], ffn_w_down[l, 1])
        if layer % 2 == 0:
            e = layer // 2
            mixer = lambda h, e=e, l=layer: hybrid_mixer(h, positions, hyb_w_in[e], hyb_w_out[e],
                                                         attn_sink[e], lb_all[l], hgrn_norm_w[e])
        else:
            o = layer // 2
            mixer = lambda h, o=o: mla(h, positions, mla_w_down[o], mla_q_norm[o], mla_kv_norm[o],
                                       mla_w_uq[o], mla_w_ukv[o], mla_w_out[o])
        x = modulated_sublayer(x, mod[:, 0], ln_g[layer, 0], ln_b[layer, 0], ffn_pre, 0.5)
        x = modulated_sublayer(x, mod[:, 1], ln_g[layer, 1], ln_b[layer, 1], mixer, 1.0)
        x = modulated_sublayer(x, mod[:, 2], ln_g[layer, 2], ln_b[layer, 2], ffn_post, 0.5)
    return x
```

```cpp
#include <hip/hip_runtime.h>
#include <hip/hip_cooperative_groups.h>
#include <cstdio>
#include <cstdint>
#include <cstring>
#include <cmath>
namespace cg = cooperative_groups;
namespace pg8 {
#define PG8_LAS __attribute__((address_space(3)))
typedef unsigned short bf16_t;
typedef short bf16x8 __attribute__((ext_vector_type(8)));
typedef float f32x4 __attribute__((ext_vector_type(4)));
typedef unsigned u32x4 __attribute__((ext_vector_type(4)));
constexpr int BM = 256, BK = 64, HALF = 128, HTB = HALF * BK * 2  , STAGE_BYTES = 8 * HTB, NXCD = 8, WGM = 8;

__host__ __device__ __forceinline__ int lds_byte(int r, int c) { const int st = (r >> 4) * 2 + (c >> 5), rr = r & 15, cc = c & 31, ob = rr * 64 + cc * 2; return st * 1024 + (ob ^ (((ob >> 9) & 1) << 5)); }
__host__ __device__ __forceinline__ void stage_rc(int b, int& R, int& C) { const int st = b / 1024, sb = b % 1024, swz = sb ^ (((sb >> 9) & 1) << 5); R = (st >> 1) * 16 + swz / 64; C = (st & 1) * 32 + (swz % 64) / 2; }
__host__ __device__ __forceinline__ int perm32(int rho) { const int n = rho >> 4, i = rho & 15; return 8 * (i >> 2) + 4 * n + (i & 3); }

struct Unit { int pm, pn; };
struct Gemm { const bf16_t* A; const bf16_t* Bt; int M, N, K, lda; };

struct StaticOrder {
    int nM, nN, nwg, G, c;
    __host__ __device__ void init(int M, int N, int G_, int c_) { nM = M / BM; nN = N / BM; nwg = nM * nN; G = G_; c = c_; }
    __host__ __device__ bool next(int i, Unit& u) const {
        const long L = (long)i * G + c; if (L >= nwg) return false;
        int wgid = (int)L; { const int q = nwg / NXCD, r = nwg % NXCD, xcd = wgid % NXCD, off = wgid / NXCD; wgid = (xcd < r ? xcd * (q + 1) : r * (q + 1) + (xcd - r) * q) + off; }
        const int nig = WGM * nN, gid = wgid / nig, fm = gid * WGM, gsz = (nM - fm) < WGM ? (nM - fm) : WGM;
        u.pm = fm + ((wgid % nig) % gsz); u.pn = (wgid % nig) / gsz; return true;
    }
    __device__ __forceinline__ void a_ready(const Unit&) const {}
    __device__ __forceinline__ void done(const Unit&) const {}
};

template <class Epi, class Sched, bool ALIGN_EPI = false, bool SP2 = false>
__device__ __forceinline__ void gemm_phase(PG8_LAS unsigned char* lds, const Gemm g, const Sched& S, const Epi& E) {
    int tid_ = threadIdx.x; asm volatile("" : "+v"(tid_)); const int tid = tid_, wid = __builtin_amdgcn_readfirstlane(tid >> 6), lane = tid & 63, wr = wid >> 2, wc = wid & 3, fr = lane & 15, fq = lane >> 4;
    const int K = g.K, nt = K / BK;
    unsigned voffA[2], voffB[2];
#pragma unroll
    for (int i = 0; i < 2; ++i) { int R, C; stage_rc(tid * 16 + i * 8192, R, C); const int Rb = Epi::PERM ? ((R & ~31) + perm32(R & 31)) : R;
        voffA[i] = (unsigned)(R * g.lda + C) * 2u; voffB[i] = (unsigned)(Rb * K + C) * 2u; }
    const size_t kstep = (size_t)(BK * 2);
    const size_t hstep = (size_t)HALF * K * 2;
    const size_t tstep = 2 * hstep; const size_t hstepA = (size_t)HALF * g.lda * 2, tstepA = 2 * hstepA;
    const unsigned ldsw = (unsigned)wid * 1024u;
    const int aoff = lds_byte(wr * 64 + fr, fq * 8), boff = lds_byte(wc * 32 + fr, fq * 8);
#define PG8_SA(b, h) (((b) * 2 + (h)) * HTB)
#define PG8_SB(b, h) ((4 + (b) * 2 + (h)) * HTB)
#define PG8_STAGE(bufoff, gbase, voff) do { _Pragma("unroll") for (int _i = 0; _i < 2; ++_i) \
        __builtin_amdgcn_global_load_lds((const unsigned*)((const char*)(gbase) + (voff)[_i]), (PG8_LAS unsigned*)(lds + (bufoff) + ldsw + _i * 8192), 16, 0, 0); } while (0)
#define PG8_LDA(dst, b, h) do { _Pragma("unroll") for (int m = 0; m < 4; ++m) _Pragma("unroll") for (int k = 0; k < 2; ++k) dst[m][k] = *(const PG8_LAS bf16x8*)(lds + PG8_SA(b, h) + aoff + m * 2048 + k * 1024); } while (0)
#define PG8_LDB(dst, b, h) do { _Pragma("unroll") for (int n = 0; n < 2; ++n) _Pragma("unroll") for (int k = 0; k < 2; ++k) dst[n][k] = *(const PG8_LAS bf16x8*)(lds + PG8_SB(b, h) + boff + n * 2048 + k * 1024); } while (0)
#define PG8_MMA(ai, bj, At, Bt) do { __builtin_amdgcn_s_setprio(1); _Pragma("unroll") for (int m = 0; m < 4; ++m) _Pragma("unroll") for (int n = 0; n < 2; ++n) _Pragma("unroll") for (int k = 0; k < 2; ++k) \
        acc[ai][bj][m][n] = __builtin_amdgcn_mfma_f32_16x16x32_bf16(Bt[n][k], At[m][k], acc[ai][bj][m][n], 0, 0, 0); __builtin_amdgcn_s_setprio(0); } while (0)
#define PG8_WAIT_V(n) asm volatile("s_waitcnt vmcnt(" #n ")" ::: "memory")
#define PG8_WAIT_L(n) asm volatile("s_waitcnt lgkmcnt(" #n ")" ::: "memory")
#define PG8_BAR __builtin_amdgcn_s_barrier()
#define PG8_SCHED __builtin_amdgcn_sched_barrier(0)
    Unit cur, nxt; int ui = 0;
    if (!S.next(0, cur)) return;
    f32x4 acc[2][2][4][2];
#pragma unroll
    for (int a = 0; a < 2; ++a)
#pragma unroll
        for (int b = 0; b < 2; ++b)
#pragma unroll
            for (int m = 0; m < 4; ++m)
#pragma unroll
                for (int n = 0; n < 2; ++n) acc[a][b][m][n] = (f32x4){0.f, 0.f, 0.f, 0.f};
    bf16x8 At[4][2], B0[2][2], B1[2][2];
    const char* cA = (const char*)g.A + (size_t)cur.pm * tstepA; const char* cB = (const char*)g.Bt + (size_t)cur.pn * tstep;
    S.a_ready(cur);
    if constexpr (SP2) {
        PG8_STAGE(PG8_SB(0, 0), cB, voffB); PG8_STAGE(PG8_SB(0, 1), cB + hstep, voffB); PG8_STAGE(PG8_SA(0, 0), cA, voffA); PG8_STAGE(PG8_SA(0, 1), cA + hstepA, voffA);
        if (wr == 1) PG8_BAR;
        PG8_WAIT_V(2); PG8_BAR;
        PG8_STAGE(PG8_SB(1, 0), cB + kstep, voffB); PG8_STAGE(PG8_SA(1, 0), cA + kstep, voffA); PG8_STAGE(PG8_SB(1, 1), cB + hstep + kstep, voffB);
        PG8_WAIT_V(6); PG8_BAR;
    } else {
        PG8_STAGE(PG8_SB(0, 0), cB, voffB); PG8_STAGE(PG8_SA(0, 0), cA, voffA); PG8_STAGE(PG8_SB(0, 1), cB + hstep, voffB); PG8_STAGE(PG8_SA(0, 1), cA + hstepA, voffA);
        if (wr == 1) PG8_BAR;
        PG8_WAIT_V(4); PG8_BAR;
        PG8_STAGE(PG8_SB(1, 0), cB + kstep, voffB); PG8_STAGE(PG8_SA(1, 0), cA + kstep, voffA); PG8_STAGE(PG8_SB(1, 1), cB + hstep + kstep, voffB);
        PG8_WAIT_V(6); PG8_BAR;
    }
    for (;;) {
        const bool has_next = S.next(ui + 1, nxt);
        const char* nA = has_next ? (const char*)g.A + (size_t)nxt.pm * tstepA : cA; const char* nB = has_next ? (const char*)g.Bt + (size_t)nxt.pn * tstep : cB;
        for (int t = 0; t < nt; t += 2) {
            const bool last = (t == nt - 2);
            const char* a1 = cA + (size_t)(t + 1) * kstep;
            const char* a2 = last ? nA : cA + (size_t)(t + 2) * kstep; const char* b2 = last ? nB : cB + (size_t)(t + 2) * kstep;
            const char* a3 = a2 + kstep; const char* b3 = b2 + kstep;
            if (last && has_next) S.a_ready(nxt);
            if constexpr (SP2) {
            PG8_LDB(B0, 0, 0); PG8_LDB(B1, 0, 1); PG8_SCHED; PG8_LDA(At, 0, 0); PG8_STAGE(PG8_SA(1, 1), a1 + hstepA, voffA);
            PG8_WAIT_V(8); PG8_WAIT_L(0); PG8_BAR; PG8_MMA(0, 0, At, B0); PG8_MMA(0, 1, At, B1); PG8_BAR; PG8_SCHED;
            PG8_LDA(At, 0, 1); PG8_STAGE(PG8_SB(0, 0), b2, voffB); PG8_STAGE(PG8_SB(0, 1), b2 + hstep, voffB); PG8_STAGE(PG8_SA(0, 0), a2, voffA);
            PG8_WAIT_V(8); PG8_WAIT_L(0); PG8_BAR; PG8_MMA(1, 0, At, B0); PG8_MMA(1, 1, At, B1); PG8_BAR; PG8_SCHED;
            PG8_LDB(B0, 1, 0); PG8_LDB(B1, 1, 1); PG8_SCHED; PG8_LDA(At, 1, 0); PG8_STAGE(PG8_SA(0, 1), a2 + hstepA, voffA);
            PG8_WAIT_V(8); PG8_WAIT_L(0); PG8_BAR; PG8_MMA(0, 0, At, B0); PG8_MMA(0, 1, At, B1); PG8_BAR; PG8_SCHED;
            PG8_LDA(At, 1, 1); PG8_STAGE(PG8_SB(1, 0), b3, voffB); PG8_STAGE(PG8_SB(1, 1), b3 + hstep, voffB); PG8_STAGE(PG8_SA(1, 0), a3, voffA);
            PG8_WAIT_V(8); PG8_WAIT_L(0); PG8_BAR; PG8_MMA(1, 0, At, B0); PG8_MMA(1, 1, At, B1); PG8_BAR; PG8_SCHED;
            } else {
            PG8_LDB(B0, 0, 0); PG8_SCHED; PG8_LDA(At, 0, 0); PG8_STAGE(PG8_SA(1, 1), a1 + hstepA, voffA);
            PG8_WAIT_L(8); PG8_BAR; PG8_WAIT_L(0); PG8_MMA(0, 0, At, B0); PG8_BAR; PG8_SCHED;
            PG8_LDB(B1, 0, 1); PG8_STAGE(PG8_SB(0, 0), b2, voffB);
            PG8_BAR; PG8_WAIT_L(0); PG8_MMA(0, 1, At, B1); PG8_BAR;
            PG8_LDA(At, 0, 1); PG8_STAGE(PG8_SA(0, 0), a2, voffA);
            PG8_BAR; PG8_WAIT_L(0); PG8_MMA(1, 0, At, B0); PG8_BAR; PG8_SCHED;
            PG8_STAGE(PG8_SB(0, 1), b2 + hstep, voffB);
            PG8_WAIT_V(6); PG8_BAR; PG8_MMA(1, 1, At, B1); PG8_BAR;
            PG8_LDB(B0, 1, 0); PG8_SCHED; PG8_LDA(At, 1, 0); PG8_STAGE(PG8_SA(0, 1), a2 + hstepA, voffA);
            PG8_WAIT_L(8); PG8_BAR; PG8_WAIT_L(0); PG8_MMA(0, 0, At, B0); PG8_BAR; PG8_SCHED;
            PG8_LDB(B1, 1, 1); PG8_STAGE(PG8_SB(1, 0), b3, voffB);
            PG8_BAR; PG8_WAIT_L(0); PG8_MMA(0, 1, At, B1); PG8_BAR;
            PG8_LDA(At, 1, 1); PG8_STAGE(PG8_SA(1, 0), a3, voffA);
            PG8_BAR; PG8_WAIT_L(0); PG8_MMA(1, 0, At, B0); PG8_BAR; PG8_SCHED;
            PG8_STAGE(PG8_SB(1, 1), b3 + hstep, voffB);
            PG8_WAIT_V(6); PG8_BAR; PG8_MMA(1, 1, At, B1); PG8_BAR;
            }
        }
        if constexpr (ALIGN_EPI) { if (wr == 0) PG8_BAR; }
        if constexpr (!Epi::AFTER_DRAIN) { E(acc, cur, wr, wc, fr, fq); S.done(cur); }
        if (!has_next) break;
#pragma unroll
        for (int a = 0; a < 2; ++a)
#pragma unroll
            for (int b = 0; b < 2; ++b)
#pragma unroll
                for (int m = 0; m < 4; ++m)
#pragma unroll
                    for (int n = 0; n < 2; ++n) acc[a][b][m][n] = (f32x4){0.f, 0.f, 0.f, 0.f};
        cur = nxt; cA = nA; cB = nB; ++ui;
        if constexpr (ALIGN_EPI) { if (wr == 1) PG8_BAR; }
    }
    PG8_WAIT_V(0);
    if constexpr (!ALIGN_EPI) { if (wr == 0) PG8_BAR; }
    PG8_BAR;
    if constexpr (Epi::AFTER_DRAIN) { E.fused(acc, cur, wr, wc, fr, fq, lds, wid, lane); S.done(cur); }
#undef PG8_SA
#undef PG8_SB
#undef PG8_STAGE
#undef PG8_LDA
#undef PG8_LDB
#undef PG8_MMA
#undef PG8_WAIT_V
#undef PG8_WAIT_L
#undef PG8_BAR
#undef PG8_SCHED
}
}

using pg8::bf16_t; using pg8::bf16x8; using pg8::f32x4; using pg8::u32x4;
#define LAS __attribute__((address_space(3)))
typedef float f32x16 __attribute__((ext_vector_type(16)));
typedef float f32x2 __attribute__((ext_vector_type(2)));
typedef unsigned u32x2 __attribute__((ext_vector_type(2)));
typedef __bf16 bf16x2_t __attribute__((ext_vector_type(2)));
__device__ __forceinline__ unsigned cvtpk(float lo, float hi) { f32x2 v = {lo, hi}; bf16x2_t b = __builtin_convertvector(v, bf16x2_t); return __builtin_bit_cast(unsigned, b); }
__device__ __forceinline__ float bf2f(unsigned short h) { return __uint_as_float(((unsigned)h) << 16); }
__device__ __forceinline__ float bflo(unsigned w) { return __uint_as_float(w << 16); }
__device__ __forceinline__ float bfhi(unsigned w) { return __uint_as_float(w & 0xffff0000u); }
__device__ __forceinline__ float fsilu(float v) { return v * __builtin_amdgcn_rcpf(1.f + __expf(-v)); }
__device__ __forceinline__ float fsigm(float v) { return __builtin_amdgcn_rcpf(1.f + __expf(-v)); }

constexpr int NT = 512;
constexpr int MROWS = 65536, DM = 1024, FF = 2816, SEQ = 4096, NB = 16, HYB_IN = 3328;
constexpr float ALPHA = 1.4142135623730951f;
constexpr float LN_EPS = 1e-5f, RMS_EPS = 1e-6f;
constexpr float LOG2E = 1.4426950408889634f;
constexpr float MLA_C2 = 0.10206207261596575f * LOG2E;
constexpr float WIN_C2 = 0.125f * LOG2E;
constexpr int LDS_BYTES = 155648;

constexpr size_t MiB = 1u << 20;
constexpr size_t WS_MOD = 1 * MiB;
constexpr size_t WS_ROPE = 4 * MiB;
constexpr size_t WS_SS = 12 * MiB;
constexpr size_t WS_KR = 14 * MiB;
constexpr size_t WS_WGU = 20 * MiB;
constexpr size_t WS_WD = 64 * MiB;
constexpr size_t WS_WHIN = 86 * MiB;
constexpr size_t WS_WHOUT = 93 * MiB;
constexpr size_t WS_WMD = 95 * MiB;
constexpr size_t WS_WUQ = 97 * MiB;
constexpr size_t WS_WUKV = 98 * MiB;
constexpr size_t WS_WMO = 99 * MiB;
constexpr size_t WS_H = 112 * MiB;
constexpr size_t WS_BIG = 240 * MiB;
constexpr size_t WS_OF = 656 * MiB;
constexpr size_t WS_END = 912 * MiB;

struct WJob { const float* src; bf16_t* dst; const float* kscale; int K, N, row_off, rmul, item0, pad; };
constexpr int NJOBS = 18;
struct Args {
    const float *x, *c; const int* pos; const float *ada_w, *ada_b, *ln_g, *ln_b, *sink, *lb_logits, *hnorm_w;
    float* out; unsigned char* ws;
    WJob jobs[NJOBS]; int nitems; int pad0;
    double freq[16];
};

struct EpiGU {
    static constexpr bool PERM = true, AFTER_DRAIN = false;
    bf16_t* O; int ldc;
    __device__ __forceinline__ void operator()(const f32x4 (&acc)[2][2][4][2], const pg8::Unit& u, int wr, int wc, int fr, int fq) const {
        const int row0 = u.pm * 256 + wr * 64 + fr; const int col0 = u.pn * 128 + wc * 16 + 4 * fq;
#pragma unroll
        for (int ai = 0; ai < 2; ++ai)
#pragma unroll
            for (int m = 0; m < 4; ++m) { bf16_t* rowp = O + (size_t)(row0 + ai * 128 + m * 16) * ldc + col0;
#pragma unroll
                for (int bj = 0; bj < 2; ++bj) { const f32x4 v0 = acc[ai][bj][m][0], v1 = acc[ai][bj][m][1];
                    u32x2 w; w.x = cvtpk(fsilu(v0[0]) * v0[1], fsilu(v0[2]) * v0[3]); w.y = cvtpk(fsilu(v1[0]) * v1[1], fsilu(v1[2]) * v1[3]);
                    *(u32x2*)(rowp + bj * 64) = w; } }
    }
};
struct EpiRes {
    static constexpr bool PERM = true, AFTER_DRAIN = false;
    const float* xin; float* zout; const float* gate; float resw;
    __device__ __forceinline__ void operator()(const f32x4 (&acc)[2][2][4][2], const pg8::Unit& u, int wr, int wc, int fr, int fq) const {
        const int row0 = u.pm * 256 + wr * 64 + fr; const float* gp = gate + (size_t)(u.pm >> 4) * 9216;
#pragma unroll
        for (int bj = 0; bj < 2; ++bj) { const int col = u.pn * 256 + bj * 128 + wc * 32 + 8 * fq;
            const f32x4 g0 = (*(const f32x4*)(gp + col) + 1.f) * resw, g1 = (*(const f32x4*)(gp + col + 4) + 1.f) * resw;
#pragma unroll
            for (int ai = 0; ai < 2; ++ai)
#pragma unroll
                for (int m = 0; m < 4; ++m) { const size_t off = (size_t)(row0 + ai * 128 + m * 16) * DM + col;
                    const f32x4 x0 = *(const f32x4*)(xin + off), x1 = *(const f32x4*)(xin + off + 4);
                    *(f32x4*)(zout + off) = x0 * ALPHA + g0 * acc[ai][bj][m][0]; *(f32x4*)(zout + off + 4) = x1 * ALPHA + g1 * acc[ai][bj][m][1]; } }
    }
};
struct EpiPlain {
    static constexpr bool PERM = true, AFTER_DRAIN = false;
    bf16_t* O; int ldc; float* SS;
    __device__ __forceinline__ void operator()(const f32x4 (&acc)[2][2][4][2], const pg8::Unit& u, int wr, int wc, int fr, int fq) const {
        const int row0 = u.pm * 256 + wr * 64 + fr; const int col0 = u.pn * 256 + wc * 32 + 8 * fq;
#pragma unroll
        for (int ai = 0; ai < 2; ++ai)
#pragma unroll
            for (int m = 0; m < 4; ++m) { const int row = row0 + ai * 128 + m * 16; bf16_t* rowp = O + (size_t)row * ldc + col0; float s = 0.f;
#pragma unroll
                for (int bj = 0; bj < 2; ++bj) { const f32x4 v0 = acc[ai][bj][m][0], v1 = acc[ai][bj][m][1];
                    s += (v0[0] * v0[0] + v0[1] * v0[1]) + (v0[2] * v0[2] + v0[3] * v0[3]) + (v1[0] * v1[0] + v1[1] * v1[1]) + (v1[2] * v1[2] + v1[3] * v1[3]);
                    u32x4 w; w.x = cvtpk(v0[0], v0[1]); w.y = cvtpk(v0[2], v0[3]); w.z = cvtpk(v1[0], v1[1]); w.w = cvtpk(v1[2], v1[3]);
                    *(u32x4*)(rowp + bj * 128) = w; }
                if (SS) { s += __shfl_xor(s, 16); s += __shfl_xor(s, 32); if (fq == 0 && u.pn < 2) SS[(size_t)row * 8 + u.pn * 4 + wc] = s; } }
    }
};
struct EpiUp {
    static constexpr bool PERM = true, AFTER_DRAIN = false;
    bf16_t* O; int ldc; const float* SS; int ssoff; float scale;
    __device__ __forceinline__ void operator()(const f32x4 (&acc)[2][2][4][2], const pg8::Unit& u, int wr, int wc, int fr, int fq) const {
        const int row0 = u.pm * 256 + wr * 64 + fr;
#pragma unroll
        for (int ai = 0; ai < 2; ++ai)
#pragma unroll
            for (int m = 0; m < 4; ++m) { const int row = row0 + ai * 128 + m * 16;
                const f32x4 ss = *(const f32x4*)(SS + (size_t)row * 8 + ssoff);
                const float r = rsqrtf(((ss[0] + ss[1]) + (ss[2] + ss[3])) * (1.f / 256.f) + RMS_EPS) * scale;
#pragma unroll
                for (int bj = 0; bj < 2; ++bj) { const int g = u.pn * 256 + bj * 128 + wc * 32;
                    f32x4 v0 = acc[ai][bj][m][0] * r, v1 = acc[ai][bj][m][1] * r;
                    u32x4 w; w.x = cvtpk(v0[0], v0[1]); w.y = cvtpk(v0[2], v0[3]); w.z = cvtpk(v1[0], v1[1]); w.w = cvtpk(v1[2], v1[3]);
                    *(u32x4*)(O + (size_t)row * ldc + g + 8 * fq) = w; }
                asm volatile("" ::: "memory"); }
    }
};

__device__ __forceinline__ float wave_sum(float v) {
#pragma unroll
    for (int o = 1; o < 64; o <<= 1) v += __shfl_xor(v, o);
    return v;
}
__device__ __forceinline__ void modulate_rows(const float* x, bf16_t* H, const float* modp  , int gw, int ngw, int lane) {
    for (int row = gw; row < MROWS; row += ngw) {
        const float* mp = modp + (size_t)(row >> 12) * 9216;
        const f32x4* xr = (const f32x4*)(x + (size_t)row * DM) + lane;
        unsigned long long* o8 = (unsigned long long*)(H + (size_t)row * DM) + lane;
#pragma unroll
        for (int j = 0; j < 4; ++j) { const f32x4 v = xr[64 * j]; const f32x4 sh = *((const f32x4*)mp + lane + 64 * j), sc = *((const f32x4*)(mp + 1024) + lane + 64 * j);
            const f32x4 h = v * (sc + 1.f) + sh;
            o8[64 * j] = (unsigned long long)cvtpk(h[0], h[1]) | ((unsigned long long)cvtpk(h[2], h[3]) << 32); }
    }
}
__device__ __forceinline__ void ln_rows(float* X, bf16_t* H, const float* lg, const float* lb, const float* modn, int gw, int ngw, int lane) {
    for (int row = gw; row < MROWS; row += ngw) {
        f32x4* xr = (f32x4*)(X + (size_t)row * DM) + lane;
        f32x4 v[4]; float s = 0.f;
#pragma unroll
        for (int j = 0; j < 4; ++j) { v[j] = xr[64 * j]; s += (v[j][0] + v[j][1]) + (v[j][2] + v[j][3]); }
        const float mean = wave_sum(s) * (1.f / DM); float s2 = 0.f;
#pragma unroll
        for (int j = 0; j < 4; ++j) { v[j] = v[j] - mean; s2 += (v[j][0] * v[j][0] + v[j][1] * v[j][1]) + (v[j][2] * v[j][2] + v[j][3] * v[j][3]); }
        const float rstd = rsqrtf(wave_sum(s2) * (1.f / DM) + LN_EPS);
        const float* mp = modn ? modn + (size_t)(row >> 12) * 9216 : nullptr;
        unsigned long long* o8 = (unsigned long long*)(H + (size_t)row * DM) + lane;
#pragma unroll
        for (int j = 0; j < 4; ++j) { const f32x4 g = *((const f32x4*)lg + lane + 64 * j), b = *((const f32x4*)lb + lane + 64 * j);
            const f32x4 y = v[j] * rstd * g + b; xr[64 * j] = y;
            if (modn) { const f32x4 sh = *((const f32x4*)mp + lane + 64 * j), sc = *((const f32x4*)(mp + 1024) + lane + 64 * j); const f32x4 h = y * (sc + 1.f) + sh;
                o8[64 * j] = (unsigned long long)cvtpk(h[0], h[1]) | ((unsigned long long)cvtpk(h[2], h[3]) << 32); } }
    }
}
__device__ __forceinline__ void hgrn_combine(const bf16_t* OF, const bf16_t* PRJ, const float* nw, bf16_t* O, int gw, int ngw, int lane) {
    for (int row = gw; row < MROWS; row += ngw) {
        const u32x4 a = *((const u32x4*)(OF + (size_t)row * 512) + lane), b = *((const u32x4*)(OF + (size_t)MROWS * 512 + (size_t)row * 512) + lane);
        const u32x4 gq = *((const u32x4*)(PRJ + (size_t)row * HYB_IN + 2816) + lane);
        float o[8]; float s = 0.f;
#pragma unroll
        for (int i = 0; i < 4; ++i) { o[2 * i] = bflo(a[i]) + bflo(b[i]); o[2 * i + 1] = bfhi(a[i]) + bfhi(b[i]); s += o[2 * i] * o[2 * i] + o[2 * i + 1] * o[2 * i + 1]; }
        s += __shfl_xor(s, 1); s += __shfl_xor(s, 2); s += __shfl_xor(s, 4); s += __shfl_xor(s, 8);
        const float r = rsqrtf(s * (1.f / 128.f) + RMS_EPS);
        const f32x4 w0 = *((const f32x4*)nw + 2 * lane), w1 = *((const f32x4*)nw + 2 * lane + 1);
        const float w[8] = {w0[0], w0[1], w0[2], w0[3], w1[0], w1[1], w1[2], w1[3]};
        float y[8];
#pragma unroll
        for (int i = 0; i < 4; ++i) { y[2 * i] = o[2 * i] * r * w[2 * i] * fsilu(bflo(gq[i])); y[2 * i + 1] = o[2 * i + 1] * r * w[2 * i + 1] * fsilu(bfhi(gq[i])); }
        u32x4 ov; ov.x = cvtpk(y[0], y[1]); ov.y = cvtpk(y[2], y[3]); ov.z = cvtpk(y[4], y[5]); ov.w = cvtpk(y[6], y[7]);
        *((u32x4*)(O + (size_t)row * DM + 512) + lane) = ov;
    }
}

__device__ __forceinline__ int crow(int r, int hi) { return (r & 3) + 8 * (r >> 2) + 4 * hi; }
#define MFMA32(a, b, c) __builtin_amdgcn_mfma_f32_32x32x16_bf16((a), (b), (c), 0, 0, 0)
template <int DQK, bool WIN> struct AttnCfg {
    static constexpr int CPR = DQK / 8, KP = DQK * 2 + 16, VP = 264, KBYTES = 128 * KP, VBYTES = 64 * VP, BUF = KBYTES + VBYTES + 512, NKC = 128 * CPR / NT, NKS = DQK / 16;
};
struct AttnUnitArgs {
    const bf16_t* Q;
    const bf16_t* Kn; size_t pitchK;
    const bf16_t* Kr;
    const bf16_t* V; size_t pitchV;
    bf16_t* O;
    int kt0, nkt;
    const float* ropeq;
    const int* posb; int qpos; int qi; int jt0; float slope2, sink2;
};
template <int DQK, bool WIN>
__device__ __forceinline__ void attn_unit(LAS unsigned char* lds, const AttnUnitArgs& A, int tid, int lane) {
    typedef AttnCfg<DQK, WIN> C;
    const int hi = lane >> 5, l31 = lane & 31;
    const int vkp = tid & 63, vdc = tid >> 6;
    u32x4 kreg[C::NKC], vreg[2]; int preg = 0;
    auto load_tile = [&](int kt) {
        const size_t r0 = (size_t)kt * 128;
#pragma unroll
        for (int i = 0; i < C::NKC; ++i) { const int c = tid + NT * i, row = c / C::CPR, cc = c % C::CPR;
            if (DQK == 96 && cc >= 8) kreg[i] = *(const u32x4*)(A.Kr + (r0 + row) * 32 + (cc - 8) * 8);
            else kreg[i] = *(const u32x4*)(A.Kn + (r0 + row) * A.pitchK + cc * 8); }
        vreg[0] = *(const u32x4*)(A.V + (r0 + 2 * vkp) * A.pitchV + vdc * 8);
        vreg[1] = *(const u32x4*)(A.V + (r0 + 2 * vkp + 1) * A.pitchV + vdc * 8);
        if (WIN && tid < 128) preg = A.posb[r0 + tid];
    };
    auto store_tile = [&](int buf) {
        LAS unsigned char* base = lds + buf * C::BUF;
#pragma unroll
        for (int i = 0; i < C::NKC; ++i) { const int c = tid + NT * i, row = c / C::CPR, cc = c % C::CPR; *(LAS u32x4*)(base + row * C::KP + cc * 16) = kreg[i]; }
        LAS unsigned char* vb = base + C::KBYTES;
#pragma unroll
        for (int j = 0; j < 4; ++j) {
            const unsigned a = vreg[0][j], b = vreg[1][j];
            *(LAS unsigned*)(vb + (8 * vdc + 2 * j) * C::VP + vkp * 4) = (a & 0xffffu) | (b << 16);
            *(LAS unsigned*)(vb + (8 * vdc + 2 * j + 1) * C::VP + vkp * 4) = (a >> 16) | (b & 0xffff0000u);
        }
        if (WIN && tid < 128) *(LAS int*)(base + C::KBYTES + C::VBYTES + tid * 4) = preg;
    };
    bf16x8 qf[C::NKS];
#pragma unroll
    for (int ks = 0; ks < C::NKS; ++ks) qf[ks] = *(const bf16x8*)(A.Q + 16 * ks + 8 * hi);
    if (!WIN && DQK == 96) {
        const float* cs = A.ropeq + 16 * hi; u32x4 w1 = __builtin_bit_cast(u32x4, qf[DQK == 96 ? 4 : 0]), w2 = __builtin_bit_cast(u32x4, qf[DQK == 96 ? 5 : 0]);
#pragma unroll
        for (int e = 0; e < 4; ++e) { const f32x4 c = *(const f32x4*)(cs + 4 * e);
            const float x1a = bflo(w1[e]), x1b = bfhi(w1[e]), x2a = bflo(w2[e]), x2b = bfhi(w2[e]);
            w1[e] = cvtpk(x1a * c[0] - x2a * c[1], x1b * c[2] - x2b * c[3]); w2[e] = cvtpk(x1a * c[1] + x2a * c[0], x1b * c[3] + x2b * c[2]); }
        qf[DQK == 96 ? 4 : 0] = __builtin_bit_cast(bf16x8, w1); qf[DQK == 96 ? 5 : 0] = __builtin_bit_cast(bf16x8, w2);
    }
    f32x16 o0, o1;
#pragma unroll
    for (int r = 0; r < 16; ++r) { o0[r] = 0.f; o1[r] = 0.f; }
    float mrun = WIN ? A.sink2 : -1e30f, lrun = (WIN && hi == 0) ? 1.f : 0.f;
    load_tile(A.kt0); store_tile(0); __syncthreads();
    for (int it = 0; it < A.nkt; ++it) {
        const bool more = it + 1 < A.nkt;
        if (more) load_tile(A.kt0 + it + 1);
        const LAS unsigned char* Kl = lds + (it & 1) * C::BUF; const LAS unsigned char* Vl = Kl + C::KBYTES; const LAS int* Pl = (const LAS int*)(Vl + C::VBYTES);
        f32x16 s[4];
#pragma unroll
        for (int kb = 0; kb < 4; ++kb) {
#pragma unroll
            for (int r = 0; r < 16; ++r) s[kb][r] = 0.f;
#pragma unroll
            for (int ks = 0; ks < C::NKS; ++ks) { const bf16x8 a = *(const LAS bf16x8*)(Kl + (32 * kb + l31) * C::KP + (16 * ks + 8 * hi) * 2); s[kb] = MFMA32(a, qf[ks], s[kb]); }
        }
        if (WIN) {
            const int jt = A.jt0 + it;
#pragma unroll
            for (int kb = 0; kb < 4; ++kb)
#pragma unroll
                for (int r = 0; r < 16; ++r) { const int kin = 32 * kb + crow(r, hi); const int ki = 128 * jt + kin; const int dq = A.qi - ki; const bool valid = (dq <= 128) && (dq >= -128);
                    const int dp = A.qpos - Pl[kin]; const float dist = (float)(dp < 0 ? -dp : dp);
                    const float v = s[kb][r] * WIN_C2 - A.slope2 * dist; s[kb][r] = valid ? v : -INFINITY; }
        }
        float mx = s[0][0];
#pragma unroll
        for (int kb = 0; kb < 4; ++kb)
#pragma unroll
            for (int r = 0; r < 16; ++r) mx = fmaxf(mx, s[kb][r]);
        mx = fmaxf(mx, __shfl_xor(mx, 32));
        const float mnew = fmaxf(mrun, mx); const float alpha = __builtin_amdgcn_exp2f(mrun - mnew); mrun = mnew;
        float ls = 0.f; bf16x8 pb[4][2];
#pragma unroll
        for (int kb = 0; kb < 4; ++kb) {
            float p[16];
#pragma unroll
            for (int r = 0; r < 16; ++r) { p[r] = __builtin_amdgcn_exp2f(s[kb][r] - mnew); ls += p[r]; }
#pragma unroll
            for (int j = 0; j < 2; ++j) { u32x4 w; w.x = cvtpk(p[8 * j], p[8 * j + 1]); w.y = cvtpk(p[8 * j + 2], p[8 * j + 3]); w.z = cvtpk(p[8 * j + 4], p[8 * j + 5]); w.w = cvtpk(p[8 * j + 6], p[8 * j + 7]);
                pb[kb][j] = __builtin_bit_cast(bf16x8, w); }
        }
        lrun = lrun * alpha + ls;
#pragma unroll
        for (int r = 0; r < 16; ++r) { o0[r] *= alpha; o1[r] *= alpha; }
#pragma unroll
        for (int kb = 0; kb < 4; ++kb)
#pragma unroll
            for (int j = 0; j < 2; ++j) {
                const int ko = (32 * kb + 16 * j + 4 * hi) * 2;
                { const u32x2 lo = *(const LAS u32x2*)(Vl + l31 * C::VP + ko), h2 = *(const LAS u32x2*)(Vl + l31 * C::VP + ko + 16);
                  u32x4 w; w.x = lo.x; w.y = lo.y; w.z = h2.x; w.w = h2.y; o0 = MFMA32(__builtin_bit_cast(bf16x8, w), pb[kb][j], o0); }
                { const u32x2 lo = *(const LAS u32x2*)(Vl + (32 + l31) * C::VP + ko), h2 = *(const LAS u32x2*)(Vl + (32 + l31) * C::VP + ko + 16);
                  u32x4 w; w.x = lo.x; w.y = lo.y; w.z = h2.x; w.w = h2.y; o1 = MFMA32(__builtin_bit_cast(bf16x8, w), pb[kb][j], o1); }
            }
        if (more) store_tile((it + 1) & 1);
        __syncthreads();
    }
    const float lt = lrun + __shfl_xor(lrun, 32); const float inv = 1.f / lt;
#pragma unroll
    for (int g4 = 0; g4 < 4; ++g4) {
        u32x2 w0, w1;
        w0.x = cvtpk(o0[4 * g4] * inv, o0[4 * g4 + 1] * inv); w0.y = cvtpk(o0[4 * g4 + 2] * inv, o0[4 * g4 + 3] * inv);
        w1.x = cvtpk(o1[4 * g4] * inv, o1[4 * g4 + 1] * inv); w1.y = cvtpk(o1[4 * g4 + 2] * inv, o1[4 * g4 + 3] * inv);
        *(u32x2*)(A.O + 8 * g4 + 4 * hi) = w0; *(u32x2*)(A.O + 32 + 8 * g4 + 4 * hi) = w1;
    }
}

#define MFMA16(a, b, c) __builtin_amdgcn_mfma_f32_16x16x32_bf16((a), (b), (c), 0, 0, 0)
namespace hg {
constexpr int RAWB = 64 * 256;
constexpr int PK = 272, PT = 144;
constexpr int O_RAWQ = 0, O_RAWF = RAWB, O_RAWV = 2 * RAWB, O_QA = 3 * RAWB, O_KA = O_QA + 64 * PK, O_QB = O_KA + 64 * PK, O_KET = O_QB + 64 * PK,
              O_VT = O_KET + 128 * PT, O_AM = O_VT + 128 * PT, O_SEG = O_AM + 64 * PT, O_DEC = O_SEG + 2048, O_END = O_DEC + 512;
static_assert(O_END <= LDS_BYTES, "hgrn LDS");
}
__device__ __forceinline__ void hgrn_chain(LAS unsigned char* lds, const bf16_t* PRJ, const float* lb_logits, bf16_t* OF, int chain, int tid, int lane, int wave) {
    using namespace hg;
    const int dir = chain & 1, hh = (chain >> 1) & 3, b = chain >> 3;
    const int colq = 768 + hh * 128, colf = (dir ? 1792 : 1280) + hh * 128, colv = 2304 + hh * 128;
    const int c = tid & 127, sg = tid >> 7;
    float lbv; { const float e0 = __expf(lb_logits[hh * 128 + c]), e1 = __expf(lb_logits[512 + hh * 128 + c]), e2 = __expf(lb_logits[1024 + hh * 128 + c]); lbv = e0 / (e0 + e1 + e2); }
    const int fr = lane & 15, fq = lane >> 4;
    f32x4 st[8];
#pragma unroll
    for (int i = 0; i < 8; ++i) st[i] = (f32x4){0.f, 0.f, 0.f, 0.f};
    u32x4 raw[6];
    auto prow = [&](int n, int i) -> size_t { const int T = 64 * n + i; return (size_t)b * SEQ + (dir ? (SEQ - 1 - T) : T); };
    auto load_raw = [&](int n) {
#pragma unroll
        for (int i = 0; i < 6; ++i) { const int idx = tid + NT * (i & 1), row = idx >> 4, ch = idx & 15; const int col = (i >> 1) == 0 ? colq : ((i >> 1) == 1 ? colf : colv);
            raw[i] = *(const u32x4*)(PRJ + prow(n, row) * HYB_IN + col + ch * 8); }
    };
    auto store_raw = [&]() {
#pragma unroll
        for (int i = 0; i < 6; ++i) { const int idx = tid + NT * (i & 1); *(LAS u32x4*)(lds + (i >> 1) * RAWB + idx * 16) = raw[i]; }
    };
    load_raw(0); store_raw(); __syncthreads();
    for (int n = 0; n < 64; ++n) {
        if (n + 1 < 64) load_raw(n + 1);
        float p[16], kk[16], qq[16];
        {
            float run = 0.f;
#pragma unroll
            for (int i = 0; i < 16; ++i) { const int t = 16 * sg + i;
                const float hf = bf2f(*(const LAS unsigned short*)(lds + O_RAWF + t * 256 + c * 2)), hq = bf2f(*(const LAS unsigned short*)(lds + O_RAWQ + t * 256 + c * 2));
                const float f = lbv + (1.f - lbv) * fsigm(hf); run += __logf(f); p[i] = run; kk[i] = 1.f - f; qq[i] = fsilu(hq); }
            *(LAS float*)(lds + O_SEG + (sg * 128 + c) * 4) = run;
            unsigned vw[8];
#pragma unroll
            for (int i = 0; i < 8; ++i) { const unsigned lo = *(const LAS unsigned short*)(lds + O_RAWV + (16 * sg + 2 * i) * 256 + c * 2), hi2 = *(const LAS unsigned short*)(lds + O_RAWV + (16 * sg + 2 * i + 1) * 256 + c * 2); vw[i] = lo | (hi2 << 16); }
            *(LAS u32x4*)(lds + O_VT + c * PT + sg * 32) = (u32x4){vw[0], vw[1], vw[2], vw[3]};
            *(LAS u32x4*)(lds + O_VT + c * PT + sg * 32 + 16) = (u32x4){vw[4], vw[5], vw[6], vw[7]};
        }
        __syncthreads();
        {
            const float s0 = *(const LAS float*)(lds + O_SEG + c * 4), s1 = *(const LAS float*)(lds + O_SEG + (128 + c) * 4), s2 = *(const LAS float*)(lds + O_SEG + (256 + c) * 4), s3 = *(const LAS float*)(lds + O_SEG + (384 + c) * 4);
            const float off = (sg > 0 ? s0 : 0.f) + (sg > 1 ? s1 : 0.f) + (sg > 2 ? s2 : 0.f);
            const float bmid = s0 + s1, bend = (s0 + s1) + (s2 + s3);
            const float emid = __expf(bmid), eend = __expf(bend - bmid);
            if (sg == 0) *(LAS float*)(lds + O_DEC + c * 4) = __expf(bend);
            unsigned kw[8];
#pragma unroll
            for (int i = 0; i < 16; ++i) { const int t = 16 * sg + i; const float bb = p[i] + off; const float e1 = __expf(bb - bmid), e2 = __expf(bmid - bb);
                const float qa = qq[i] * e1, ka = kk[i] * e2, qb = qa * emid, ke = ka * eend;
                *(LAS unsigned short*)(lds + O_QA + t * PK + c * 2) = (unsigned short)(cvtpk(qa, 0.f) & 0xffffu);
                *(LAS unsigned short*)(lds + O_KA + t * PK + c * 2) = (unsigned short)(cvtpk(ka, 0.f) & 0xffffu);
                *(LAS unsigned short*)(lds + O_QB + t * PK + c * 2) = (unsigned short)(cvtpk(qb, 0.f) & 0xffffu);
                if (i & 1) kw[i >> 1] |= (cvtpk(ke, 0.f) << 16); else kw[i >> 1] = cvtpk(ke, 0.f) & 0xffffu; }
            *(LAS u32x4*)(lds + O_KET + c * PT + sg * 32) = (u32x4){kw[0], kw[1], kw[2], kw[3]};
            *(LAS u32x4*)(lds + O_KET + c * PT + sg * 32 + 16) = (u32x4){kw[4], kw[5], kw[6], kw[7]};
        }
        __syncthreads();
        {
#pragma unroll
            for (int e = 0; e < 2; ++e) { const int id = wave + 8 * e, tb = id >> 2, sb = id & 3;
                f32x4 a4 = (f32x4){0.f, 0.f, 0.f, 0.f};
                if (sb <= tb) {
#pragma unroll
                    for (int ks = 0; ks < 4; ++ks) { const bf16x8 af = *(const LAS bf16x8*)(lds + O_QA + (16 * tb + fr) * PK + (32 * ks + 8 * fq) * 2), bfr = *(const LAS bf16x8*)(lds + O_KA + (16 * sb + fr) * PK + (32 * ks + 8 * fq) * 2);
                        a4 = MFMA16(af, bfr, a4); }
                }
#pragma unroll
                for (int j = 0; j < 4; ++j) { const int tok = 16 * tb + 4 * fq + j, s = 16 * sb + fr; const float v = (tok >= s) ? a4[j] : 0.f;
                    *(LAS unsigned short*)(lds + O_AM + tok * PT + s * 2) = (unsigned short)(cvtpk(v, 0.f) & 0xffffu); }
            }
        }
        f32x4 oacc[4];
        {
            bf16x8 sb16[4];
#pragma unroll
            for (int s = 0; s < 4; ++s) { u32x4 w; w.x = cvtpk(st[2 * s][0], st[2 * s][1]); w.y = cvtpk(st[2 * s][2], st[2 * s][3]); w.z = cvtpk(st[2 * s + 1][0], st[2 * s + 1][1]); w.w = cvtpk(st[2 * s + 1][2], st[2 * s + 1][3]); sb16[s] = __builtin_bit_cast(bf16x8, w); }
#pragma unroll
            for (int tb = 0; tb < 4; ++tb) { oacc[tb] = (f32x4){0.f, 0.f, 0.f, 0.f};
#pragma unroll
                for (int s = 0; s < 4; ++s) { const u32x2 lo = *(const LAS u32x2*)(lds + O_QB + (16 * tb + fr) * PK + (32 * s + 4 * fq) * 2), h2 = *(const LAS u32x2*)(lds + O_QB + (16 * tb + fr) * PK + (32 * s + 16 + 4 * fq) * 2);
                    u32x4 w; w.x = lo.x; w.y = lo.y; w.z = h2.x; w.w = h2.y; oacc[tb] = MFMA16(__builtin_bit_cast(bf16x8, w), sb16[s], oacc[tb]); } }
#pragma unroll
            for (int kb = 0; kb < 8; ++kb) { const f32x4 dc = *(const LAS f32x4*)(lds + O_DEC + (16 * kb + 4 * fq) * 4); st[kb] = st[kb] * dc;
#pragma unroll
                for (int ts = 0; ts < 2; ++ts) { const bf16x8 af = *(const LAS bf16x8*)(lds + O_KET + (16 * kb + fr) * PT + (32 * ts + 8 * fq) * 2), bfr = *(const LAS bf16x8*)(lds + O_VT + (16 * wave + fr) * PT + (32 * ts + 8 * fq) * 2);
                    st[kb] = MFMA16(af, bfr, st[kb]); } }
        }
        __syncthreads();
        {
#pragma unroll
            for (int tb = 0; tb < 4; ++tb) {
#pragma unroll
                for (int ks = 0; ks < 2; ++ks) { const bf16x8 af = *(const LAS bf16x8*)(lds + O_AM + (16 * tb + fr) * PT + (32 * ks + 8 * fq) * 2), bfr = *(const LAS bf16x8*)(lds + O_VT + (16 * wave + fr) * PT + (32 * ks + 8 * fq) * 2);
                    oacc[tb] = MFMA16(af, bfr, oacc[tb]); }
#pragma unroll
                for (int j = 0; j < 4; ++j) { const int tok = 16 * tb + 4 * fq + j;
                    OF[(size_t)dir * MROWS * 512 + prow(n, tok) * 512 + hh * 128 + 16 * wave + fr] = (unsigned short)(cvtpk(oacc[tb][j], 0.f) & 0xffffu); }
            }
        }
        if (n + 1 < 64) store_raw();
        __syncthreads();
    }
}

__device__ __forceinline__ void transpose_item(const float* W, int K, int N, bf16_t* WT, int row_off, int rmul, const float* kscale, LAS float* scr, int item, int lane) {
    const int nblk = N / 32, kb = item / nblk, nb = item % nblk, k0 = 64 * kb, n0 = 32 * nb;
#pragma unroll 8
    for (int i = 0; i < 32; ++i) { const int kk = 2 * i + (lane >> 5); float w = W[(size_t)(k0 + kk) * N + n0 + (lane & 31)]; if (kscale) w *= kscale[k0 + kk]; scr[kk * 33 + (lane & 31)] = w; }
    asm volatile("s_waitcnt lgkmcnt(0)" ::: "memory");
    const int c = lane & 7;
#pragma unroll
    for (int j = 0; j < 4; ++j) { const int n = (lane >> 3) + 8 * j; const LAS float* s = scr + (8 * c) * 33 + n;
        u32x4 o; o.x = cvtpk(s[0 * 33], s[1 * 33]); o.y = cvtpk(s[2 * 33], s[3 * 33]); o.z = cvtpk(s[4 * 33], s[5 * 33]); o.w = cvtpk(s[6 * 33], s[7 * 33]);
        *(u32x4*)(WT + (size_t)(row_off + (n0 + n) * rmul) * K + k0 + 8 * c) = o; }
    asm volatile("s_waitcnt lgkmcnt(0)" ::: "memory");
}

__global__ void __launch_bounds__(NT, 2) mega(Args a) {
    extern __shared__ __attribute__((aligned(16))) unsigned char lds_raw[];
    LAS unsigned char* lds = (LAS unsigned char*)lds_raw;
    cg::grid_group grid = cg::this_grid();
#define PH_BEGIN int tid = threadIdx.x; asm volatile("" : "+v"(tid)); const int lane = tid & 63, wave = __builtin_amdgcn_readfirstlane(tid >> 6); unsigned char* ws = a.ws; asm volatile("" : "+s"(ws)); \
    const int G = gridDim.x, bx = blockIdx.x; const int gw = bx * 8 + wave, ngw = G * 8; (void)lane; (void)gw; (void)ngw; \
    float* mod = (float*)(ws + WS_MOD); float* rope = (float*)(ws + WS_ROPE); float* SS = (float*)(ws + WS_SS); bf16_t* KR = (bf16_t*)(ws + WS_KR); \
    bf16_t* H = (bf16_t*)(ws + WS_H); bf16_t* BIG = (bf16_t*)(ws + WS_BIG); bf16_t* OF = (bf16_t*)(ws + WS_OF); float* X = a.out; \
    (void)mod; (void)rope; (void)SS; (void)KR; (void)H; (void)BIG; (void)OF; (void)X;

    {
        PH_BEGIN
        LAS float* scr = (LAS float*)(lds + wave * 16384);
        for (int it = gw; it < a.nitems; it += ngw) {
            int j = 0;
#pragma unroll 1
            while (j + 1 < NJOBS && it >= a.jobs[j + 1].item0) ++j;
            const WJob& jb = a.jobs[j];
            transpose_item(jb.src, jb.K, jb.N, jb.dst, jb.row_off, jb.rmul, jb.kscale, scr, it - jb.item0, lane);
        }
        { u32x4* z = (u32x4*)(ws + WS_WMD + (size_t)544 * 1024 * 2); const int nz = 224 * 1024 * 2 / 16;
          for (int i = bx * NT + tid; i < nz; i += G * NT) z[i] = (u32x4){0u, 0u, 0u, 0u}; }
        for (int i = bx * NT + tid; i < MROWS * 16; i += G * NT) { const int row = i >> 4, fi = i & 15;
            const double t = (double)a.pos[row] * a.freq[fi] * 0.15915494309189535; const float fr = (float)(t - floor(t));
            rope[2 * (size_t)i] = __builtin_amdgcn_cosf(fr); rope[2 * (size_t)i + 1] = __builtin_amdgcn_sinf(fr); }
        __syncthreads();
        if (bx < 144) {
            const int l = bx / 72, col0 = (bx % 72) * 128;
            LAS float* cond = (LAS float*)lds; LAS float* part = (LAS float*)(lds + 65536);
            for (int i = tid; i < 16 * 1024; i += NT) cond[i] = fsilu(a.c[i]);
            __syncthreads();
            float acc[16][2];
#pragma unroll
            for (int b = 0; b < 16; ++b) { acc[b][0] = 0.f; acc[b][1] = 0.f; }
            const float* wp = a.ada_w + ((size_t)l * 1024 + 128 * wave) * 9216 + col0 + 2 * lane;
            for (int k = 0; k < 128; k += 4) {
                f32x2 w[4];
#pragma unroll
                for (int e = 0; e < 4; ++e) w[e] = *(const f32x2*)(wp + (size_t)(k + e) * 9216);
#pragma unroll
                for (int b = 0; b < 16; ++b) { const f32x4 cb = *(const LAS f32x4*)(cond + b * 1024 + 128 * wave + k);
#pragma unroll
                    for (int e = 0; e < 4; ++e) { acc[b][0] += cb[e] * w[e][0]; acc[b][1] += cb[e] * w[e][1]; } }
            }
#pragma unroll
            for (int b = 0; b < 16; ++b) { part[(wave * 16 + b) * 128 + 2 * lane] = acc[b][0]; part[(wave * 16 + b) * 128 + 2 * lane + 1] = acc[b][1]; }
            __syncthreads();
            for (int o = tid; o < 2048; o += NT) { const int b = o >> 7, cc = o & 127; float s = a.ada_b[l * 9216 + col0 + cc];
#pragma unroll
                for (int w8 = 0; w8 < 8; ++w8) s += part[(w8 * 16 + b) * 128 + cc];
                mod[(size_t)(l * 16 + b) * 9216 + col0 + cc] = s; }
            __syncthreads();
        }
    }
    grid.sync();
    { PH_BEGIN modulate_rows(a.x, H, mod, gw, ngw, lane); }
    grid.sync();

#pragma unroll 1
    for (int s = 0; s < 6; ++s) {
        const int l = s / 3, sub = s % 3;
#define MODLS (mod + (size_t)l * 16 * 9216 + sub * 3072)
#define XIN ((s == 0) ? a.x : X)
        if (sub != 1) {
            const int f = sub >> 1;
            { PH_BEGIN const bf16_t* Wgu = (const bf16_t*)(ws + WS_WGU + (size_t)(l * 2 + f) * 11 * MiB);
              pg8::Gemm g{H, Wgu, MROWS, 2 * FF, DM, DM}; pg8::StaticOrder S; S.init(MROWS, 2 * FF, G, bx); EpiGU E{BIG, FF};
              pg8::gemm_phase<EpiGU, pg8::StaticOrder, true, true>(lds, g, S, E); }
            grid.sync();
            { PH_BEGIN const bf16_t* Wd = (const bf16_t*)(ws + WS_WD + (size_t)(l * 2 + f) * (11 * MiB / 2));
              pg8::Gemm g{BIG, Wd, MROWS, DM, FF, FF}; pg8::StaticOrder S; S.init(MROWS, DM, G, bx); EpiRes E{XIN, X, MODLS + 2048, 0.5f};
              pg8::gemm_phase<EpiRes, pg8::StaticOrder, true, true>(lds, g, S, E); }
            grid.sync();
        } else if (l == 0) {
            { PH_BEGIN pg8::Gemm g{H, (const bf16_t*)(ws + WS_WHIN), MROWS, HYB_IN, DM, DM}; pg8::StaticOrder S; S.init(MROWS, HYB_IN, G, bx); EpiPlain E{BIG, HYB_IN, nullptr};
              pg8::gemm_phase<EpiPlain, pg8::StaticOrder, true, true>(lds, g, S, E); }
            grid.sync();
            { PH_BEGIN
            if (bx < 128) {
#ifndef NO_HGRN
                hgrn_chain(lds, BIG, a.lb_logits, OF, bx, tid, lane, wave);
#endif
            } else {
#pragma unroll 1
                for (int u = bx - 128; u < 2048; u += G - 128) {
                    const int half = u & 1, hk = (u >> 1) & 1, n = (u >> 2) & 31, b = u >> 7;
                    const int h = hk * 4 + (wave >> 1), tq = half * 64 + (wave & 1) * 32 + (lane & 31);
                    const size_t qrow = (size_t)b * SEQ + n * 128 + tq;
                    AttnUnitArgs A;
                    A.Q = BIG + qrow * HYB_IN + h * 64;
                    A.Kn = BIG + (size_t)b * SEQ * HYB_IN + 512 + hk * 64; A.pitchK = HYB_IN; A.Kr = nullptr;
                    A.V = BIG + (size_t)b * SEQ * HYB_IN + 640 + hk * 64; A.pitchV = HYB_IN;
                    A.O = H + qrow * DM + h * 64;
                    const int jlo = (n == 0) ? 1 : 0, jhi = (n == 31) ? 1 : 2;
                    A.kt0 = n - 1 + jlo; A.nkt = jhi - jlo + 1; A.jt0 = jlo;
                    A.ropeq = nullptr; A.posb = a.pos + (size_t)b * SEQ; A.qpos = a.pos[qrow]; A.qi = 128 + tq;
                    A.slope2 = exp2f(-(float)(h + 1)) * LOG2E; A.sink2 = a.sink[h] * LOG2E;
#ifndef NO_WIN
                    attn_unit<64, true>(lds, A, tid, lane);
#endif
                }
            } }
            grid.sync();
            { PH_BEGIN hgrn_combine(OF, BIG, a.hnorm_w, H, gw, ngw, lane); }
            grid.sync();
            { PH_BEGIN pg8::Gemm g{H, (const bf16_t*)(ws + WS_WHOUT), MROWS, DM, DM, DM}; pg8::StaticOrder S; S.init(MROWS, DM, G, bx); EpiRes E{XIN, X, MODLS + 2048, 1.0f};
              pg8::gemm_phase<EpiRes, pg8::StaticOrder, true, true>(lds, g, S, E); }
            grid.sync();
        } else {
            { PH_BEGIN pg8::Gemm g{H, (const bf16_t*)(ws + WS_WMD), MROWS, 768, DM, DM}; pg8::StaticOrder S; S.init(MROWS, 768, G, bx); EpiPlain E{BIG, 768, SS};
              pg8::gemm_phase<EpiPlain, pg8::StaticOrder, true, true>(lds, g, S, E); }
            grid.sync();
            { PH_BEGIN const bf16_t* DWN = BIG;
            for (int i = bx * NT + tid; i < MROWS * 16; i += G * NT) { const int row = i >> 4, fi = i & 15;
                const float x1 = bf2f(DWN[(size_t)row * 768 + 512 + fi]), x2 = bf2f(DWN[(size_t)row * 768 + 528 + fi]); const float c = rope[2 * (size_t)i], sn = rope[2 * (size_t)i + 1];
                KR[(size_t)row * 32 + fi] = (unsigned short)(cvtpk(x1 * c - x2 * sn, 0.f) & 0xffffu); KR[(size_t)row * 32 + 16 + fi] = (unsigned short)(cvtpk(x1 * sn + x2 * c, 0.f) & 0xffffu); }
            }
            { PH_BEGIN bf16_t* Qb = BIG + (size_t)MROWS * 768;
              pg8::Gemm g{BIG, (const bf16_t*)(ws + WS_WUQ), MROWS, 1536, 256, 768}; pg8::StaticOrder S; S.init(MROWS, 1536, G, bx); EpiUp E{Qb, 1536, SS, 0, MLA_C2};
              pg8::gemm_phase<EpiUp, pg8::StaticOrder, true, true>(lds, g, S, E); }
            { PH_BEGIN bf16_t* KV = OF;
              pg8::Gemm g{BIG + 256, (const bf16_t*)(ws + WS_WUKV), MROWS, 2048, 256, 768}; pg8::StaticOrder S; S.init(MROWS, 2048, G, bx); EpiUp E{KV, 2048, SS, 4, 1.0f};
              pg8::gemm_phase<EpiUp, pg8::StaticOrder, true, true>(lds, g, S, E); }
            grid.sync();
            { PH_BEGIN const bf16_t* Qb = BIG + (size_t)MROWS * 768; const bf16_t* KV = OF;
            const int vcu = (G % 8 == 0) ? (bx % 8) * (G / 8) + bx / 8 : bx;
#pragma unroll 1
            for (int u = vcu; u < 4096; u += G) {
                const int qb = u & 15, bh = u >> 4, b = bh >> 4, h = bh & 15;
                const size_t qrow = (size_t)b * SEQ + qb * 256 + wave * 32 + (lane & 31);
                AttnUnitArgs A;
                A.Q = Qb + qrow * 1536 + h * 96;
                A.Kn = KV + (size_t)b * SEQ * 2048 + h * 128; A.pitchK = 2048; A.Kr = KR + (size_t)b * SEQ * 32;
                A.V = KV + (size_t)b * SEQ * 2048 + h * 128 + 64; A.pitchV = 2048;
                A.O = H + qrow * DM + h * 64;
                A.ropeq = rope + qrow * 32; A.kt0 = 0; A.nkt = 32; A.jt0 = 0; A.posb = nullptr; A.qpos = 0; A.qi = 0; A.slope2 = 0.f; A.sink2 = 0.f;
#ifndef NO_MLA
                attn_unit<96, false>(lds, A, tid, lane);
#endif
            } }
            grid.sync();
            { PH_BEGIN pg8::Gemm g{H, (const bf16_t*)(ws + WS_WMO), MROWS, DM, DM, DM}; pg8::StaticOrder S; S.init(MROWS, DM, G, bx); EpiRes E{XIN, X, MODLS + 2048, 1.0f};
              pg8::gemm_phase<EpiRes, pg8::StaticOrder, true, true>(lds, g, S, E); }
            grid.sync();
        }
        { PH_BEGIN const float* modn = nullptr; if (s < 5) { const int l2 = (s + 1) / 3, sub2 = (s + 1) % 3; modn = mod + (size_t)l2 * 16 * 9216 + sub2 * 3072; }
          ln_rows(X, H, a.ln_g + (l * 3 + sub) * DM, a.ln_b + (l * 3 + sub) * DM, modn, gw, ngw, lane); }
        if (s < 5) grid.sync();
    }
}

extern "C" void kernel_launch(void* const* d_in, const int* in_sizes, int n_in, void* d_out, int out_size, void* d_ws, size_t ws_size, hipStream_t stream) {
    static int grid = 0;
    if (grid == 0) {
        if (n_in != 21 || out_size != MROWS * DM || ws_size < WS_END) { fprintf(stderr, "kernel_launch: unexpected problem (n_in %d out %d ws %zu)\n", n_in, out_size, ws_size); grid = -1; return; }
        int dev = 0, cus = 0, per_cu = 0;
        (void)hipGetDevice(&dev); (void)hipDeviceGetAttribute(&cus, hipDeviceAttributeMultiprocessorCount, dev);
        if (hipFuncSetAttribute((const void*)mega, hipFuncAttributeMaxDynamicSharedMemorySize, LDS_BYTES) != hipSuccess) { fprintf(stderr, "kernel_launch: hipFuncSetAttribute failed\n"); grid = -1; return; }
        if (hipOccupancyMaxActiveBlocksPerMultiprocessor(&per_cu, (const void*)mega, NT, LDS_BYTES) != hipSuccess || per_cu < 1) { fprintf(stderr, "kernel_launch: occupancy query says %d\n", per_cu); per_cu = 1; }
        (void)hipGetLastError();
        grid = cus * 1;
        fprintf(stderr, "kernel_launch: grid %d (cus %d, per_cu %d)\n", grid, cus, per_cu);
    }
    if (grid < 0) return;
    Args a; memset(&a, 0, sizeof(a));
    a.x = (const float*)d_in[0]; a.c = (const float*)d_in[1]; a.pos = (const int*)d_in[2]; a.ada_w = (const float*)d_in[3]; a.ada_b = (const float*)d_in[4];
    a.ln_g = (const float*)d_in[5]; a.ln_b = (const float*)d_in[6]; a.sink = (const float*)d_in[12]; a.lb_logits = (const float*)d_in[13]; a.hnorm_w = (const float*)d_in[14];
    a.out = (float*)d_out; a.ws = (unsigned char*)d_ws;
    const float* wg = (const float*)d_in[7]; const float* wu = (const float*)d_in[8]; const float* wd = (const float*)d_in[9];
    unsigned char* ws = (unsigned char*)d_ws;
    int nj = 0, items = 0;
    auto add = [&](const float* src, size_t dst_off, const float* ks, int K, int N, int row_off, int rmul) {
        WJob& j = a.jobs[nj++]; j.src = src; j.dst = (bf16_t*)(ws + dst_off); j.kscale = ks; j.K = K; j.N = N; j.row_off = row_off; j.rmul = rmul; j.item0 = items; j.pad = 0; items += (K / 64) * (N / 32); };
    for (int lf = 0; lf < 4; ++lf) {
        add(wg + (size_t)lf * DM * FF, WS_WGU + (size_t)lf * 11 * MiB, nullptr, DM, FF, 0, 2);
        add(wu + (size_t)lf * DM * FF, WS_WGU + (size_t)lf * 11 * MiB, nullptr, DM, FF, 1, 2);
        add(wd + (size_t)lf * FF * DM, WS_WD + (size_t)lf * (11 * MiB / 2), nullptr, FF, DM, 0, 1);
    }
    add((const float*)d_in[10], WS_WHIN, nullptr, DM, HYB_IN, 0, 1);
    add((const float*)d_in[11], WS_WHOUT, nullptr, DM, DM, 0, 1);
    add((const float*)d_in[15], WS_WMD, nullptr, DM, 544, 0, 1);
    add((const float*)d_in[18], WS_WUQ, (const float*)d_in[16], 256, 1536, 0, 1);
    add((const float*)d_in[19], WS_WUKV, (const float*)d_in[17], 256, 2048, 0, 1);
    add((const float*)d_in[20], WS_WMO, nullptr, DM, DM, 0, 1);
    a.nitems = items;
    for (int i = 0; i < 16; ++i) a.freq[i] = pow(10000.0, -(double)i / 16.0);
    void* args[] = {&a};
    hipError_t e = hipLaunchCooperativeKernel((const void*)mega, dim3(grid), dim3(NT), args, LDS_BYTES, stream);
    if (e != hipSuccess) fprintf(stderr, "kernel_launch: cooperative launch failed: %s\n", hipGetErrorString(e));
}
```
